# Optimizing an MI355X kernel written in HIP

```python
import math
import jax, jax.numpy as jnp
from jax import lax
import numpy as np

D_MODEL = 1024
BATCH = 4
SEQ = 8192
DEPTH = 1

RET_HEADS = 4
RET_HEAD_DIM = 128
RET_WIDTH = RET_HEADS * RET_HEAD_DIM
RET_CHUNK = 256
MOBA_HEADS = 8
MOBA_HEAD_DIM = 64
MOBA_WIDTH = MOBA_HEADS * MOBA_HEAD_DIM
MOBA_BLOCK = 256
MOBA_TOP_K = 3
MOBA_Q_CHUNK = 64
MIX_WIDTH = RET_WIDTH + MOBA_WIDTH
IN_WIDTH = 4 * RET_WIDTH + 3 * MOBA_WIDTH
D_FF = ((8 * D_MODEL + 3 * 256 - 1) // (3 * 256)) * 256
DEEPNORM_ALPHA = (2 * DEPTH) ** 0.25
DEEPNORM_BETA = (8 * DEPTH) ** -0.25
NORM_EPS = 1e-5
NEG_INF = -1e30
SEQ_PAD_MULTIPLE = math.lcm(RET_CHUNK, MOBA_BLOCK)

kernel_name = "hybrid_retention_moba_deepnorm"


def _layer_norm(x, g, b):
    xf = x.astype(jnp.float32)
    mu = jnp.mean(xf, axis=-1, keepdims=True)
    var = jnp.mean(jnp.square(xf - mu), axis=-1, keepdims=True)
    return ((xf - mu) * lax.rsqrt(var + NORM_EPS) * g + b).astype(x.dtype)


def _split_in_proj(p):
    sizes = [RET_WIDTH, RET_WIDTH, RET_WIDTH, RET_WIDTH, MOBA_WIDTH, MOBA_WIDTH, MOBA_WIDTH]
    offs = np.cumsum([0] + sizes)
    return [p[..., int(offs[i]):int(offs[i + 1])] for i in range(len(sizes))]


def _retention(q, k, v):
    f32 = jnp.float32
    bsz, s_len, n_h, d_k = q.shape
    d_v = v.shape[-1]
    n_c = s_len // RET_CHUNK
    q = q.astype(f32).reshape(bsz, n_c, RET_CHUNK, n_h, d_k)
    k = (k.astype(f32) * d_k ** -0.5).reshape(bsz, n_c, RET_CHUNK, n_h, d_k)
    v = v.astype(f32).reshape(bsz, n_c, RET_CHUNK, n_h, d_v)
    log_g = jnp.log1p(-jnp.exp2(-5.0 - jnp.arange(n_h, dtype=f32)))
    pos = jnp.arange(RET_CHUNK, dtype=f32)
    diff = pos[:, None] - pos[None, :]
    intra_decay = jnp.where(diff >= 0.0,
                            jnp.exp(log_g[:, None, None] * jnp.maximum(diff, 0.0)), 0.0)
    scores = jnp.einsum('bnihd,bnjhd->bnhij', q, k) * intra_decay
    intra = jnp.einsum('bnhij,bnjhe->bnihe', scores, v)
    k_to_end = jnp.exp(log_g[None, :] * (RET_CHUNK - 1.0 - pos)[:, None])
    kv = jnp.einsum('bnjhd,bnjhe->nbhde', k * k_to_end[:, :, None], v)
    chunk_decay = jnp.exp(log_g * RET_CHUNK)[None, :, None, None]

    def step(state, kv_c):
        return state * chunk_decay + kv_c, state

    _, prev = lax.scan(step, jnp.zeros_like(kv[0]), kv)
    q_from_start = jnp.exp(log_g[None, :] * (pos + 1.0)[:, None])
    cross = jnp.einsum('bnihd,nbhde->bnihe', q * q_from_start[:, :, None], prev)
    return (intra + cross).reshape(bsz, s_len, n_h, d_v)


def _head_group_norm(y, gain):
    bsz, s_len, n_h, e = y.shape
    mu = jnp.mean(y, axis=-1, keepdims=True)
    var = jnp.mean(jnp.square(y - mu), axis=-1, keepdims=True)
    yn = (y - mu) * lax.rsqrt(var + NORM_EPS)
    return yn.reshape(bsz, s_len, n_h * e) * gain


def _alibi_slopes(n_heads):
    return jnp.exp2(-8.0 * (jnp.arange(n_heads, dtype=jnp.float32) + 1.0) / n_heads)


def _moba_attention(q, k, v):
    f32 = jnp.float32
    bsz, s_len, n_h, d_h = q.shape
    n_b = s_len // MOBA_BLOCK
    top_k = min(MOBA_TOP_K, n_b)
    q = jnp.transpose(q, (0, 2, 1, 3)).astype(f32) * d_h ** -0.5
    k = jnp.transpose(k, (0, 2, 1, 3)).astype(f32)
    v = jnp.transpose(v, (0, 2, 1, 3)).astype(f32)
    kb = k.reshape(bsz, n_h, n_b, MOBA_BLOCK, d_h)
    vb = v.reshape(bsz, n_h, n_b, MOBA_BLOCK, d_h)
    k_mean = jnp.mean(kb, axis=3)
    slopes = _alibi_slopes(n_h)
    b_idx = jnp.arange(bsz)[:, None, None, None]
    h_idx = jnp.arange(n_h)[None, :, None, None]
    blk_ids = jnp.arange(n_b)
    offs = jnp.arange(MOBA_BLOCK)

    def one_chunk(start):
        qc = lax.dynamic_slice_in_dim(q, start, MOBA_Q_CHUNK, axis=2)
        t_q = start + jnp.arange(MOBA_Q_CHUNK)
        own = start // MOBA_BLOCK
        gate = jnp.einsum('bhqd,bhnd->bhqn', qc, k_mean)
        gate = jnp.where(blk_ids < own, gate, NEG_INF)
        _, sel = lax.top_k(gate, top_k)
        sel_valid = jnp.arange(top_k) < own
        k_sel = kb[b_idx, h_idx, sel]
        v_sel = vb[b_idx, h_idx, sel]
        dist_sel = (t_q[None, None, :, None, None]
                    - (sel[..., None] * MOBA_BLOCK + offs)).astype(f32)
        s_sel = (jnp.einsum('bhqd,bhqkjd->bhqkj', qc, k_sel)
                 - slopes[:, None, None, None] * dist_sel)
        s_sel = jnp.where(sel_valid[:, None], s_sel, NEG_INF)
        k_own = lax.dynamic_slice_in_dim(k, own * MOBA_BLOCK, MOBA_BLOCK, axis=2)
        v_own = lax.dynamic_slice_in_dim(v, own * MOBA_BLOCK, MOBA_BLOCK, axis=2)
        dist_own = t_q[:, None] - (own * MOBA_BLOCK + offs)[None, :]
        s_own = (jnp.einsum('bhqd,bhjd->bhqj', qc, k_own)
                 - slopes[:, None, None] * dist_own.astype(f32))
        s_own = jnp.where(dist_own >= 0, s_own, NEG_INF)
        logits = jnp.concatenate(
            [s_sel.reshape(bsz, n_h, MOBA_Q_CHUNK, top_k * MOBA_BLOCK), s_own], axis=-1)
        p = jax.nn.softmax(logits, axis=-1)
        p_sel = p[..., :top_k * MOBA_BLOCK].reshape(bsz, n_h, MOBA_Q_CHUNK, top_k, MOBA_BLOCK)
        p_own = p[..., top_k * MOBA_BLOCK:]
        return (jnp.einsum('bhqkj,bhqkjd->bhqd', p_sel, v_sel)
                + jnp.einsum('bhqj,bhjd->bhqd', p_own, v_own))

    starts = jnp.arange(0, s_len, MOBA_Q_CHUNK)
    out = lax.map(one_chunk, starts)
    return jnp.transpose(out, (1, 0, 3, 2, 4)).reshape(bsz, s_len, n_h, d_h)


def setup_inputs(seed: int = 0) -> dict:
    key = jax.random.key(seed)
    ks = jax.random.split(key, 12)
    f32 = jnp.float32
    nrm = lambda k_, shp: jax.random.normal(k_, shp, f32)
    col_scale = jnp.concatenate([
        jnp.ones((2 * RET_WIDTH,), f32), jnp.full((RET_WIDTH,), DEEPNORM_BETA, f32),
        jnp.ones((RET_WIDTH,), f32), jnp.ones((2 * MOBA_WIDTH,), f32),
        jnp.full((MOBA_WIDTH,), DEEPNORM_BETA, f32)])
    x = nrm(ks[0], (BATCH, SEQ, D_MODEL))
    w_in = nrm(ks[1], (DEPTH, D_MODEL, IN_WIDTH)) * (D_MODEL ** -0.5) * col_scale
    ret_gn_gain = 1.0 + 0.02 * nrm(ks[2], (DEPTH, RET_WIDTH))
    w_out = nrm(ks[3], (DEPTH, MIX_WIDTH, D_MODEL)) * (MIX_WIDTH ** -0.5) * DEEPNORM_BETA
    ln1_g = 1.0 + 0.02 * nrm(ks[4], (DEPTH, D_MODEL))
    ln1_b = 0.02 * nrm(ks[5], (DEPTH, D_MODEL))
    w_gate = nrm(ks[6], (DEPTH, D_MODEL, D_FF)) * (D_MODEL ** -0.5) * DEEPNORM_BETA
    w_up = nrm(ks[7], (DEPTH, D_MODEL, D_FF)) * (D_MODEL ** -0.5) * DEEPNORM_BETA
    w_down = nrm(ks[8], (DEPTH, D_FF, D_MODEL)) * (D_FF ** -0.5) * DEEPNORM_BETA
    ln2_g = 1.0 + 0.02 * nrm(ks[9], (DEPTH, D_MODEL))
    ln2_b = 0.02 * nrm(ks[10], (DEPTH, D_MODEL))
    return {"x": x, "w_in": w_in, "ret_gn_gain": ret_gn_gain, "w_out": w_out,
            "ln1_g": ln1_g, "ln1_b": ln1_b, "w_gate": w_gate, "w_up": w_up,
            "w_down": w_down, "ln2_g": ln2_g, "ln2_b": ln2_b}


def reference(x, w_in, ret_gn_gain, w_out, ln1_g, ln1_b, w_gate, w_up, w_down, ln2_g, ln2_b):
    bsz, s_len, _ = x.shape
    s_pad = -(-s_len // SEQ_PAD_MULTIPLE) * SEQ_PAD_MULTIPLE
    h = x
    for layer in range(DEPTH):
        proj = h @ w_in[layer]
        proj_p = jnp.pad(proj, ((0, 0), (0, s_pad - s_len), (0, 0)))
        rq, rk, rv, rg, mq, mk, mv = _split_in_proj(proj_p)
        ret = _retention(rq.reshape(bsz, s_pad, RET_HEADS, RET_HEAD_DIM),
                         rk.reshape(bsz, s_pad, RET_HEADS, RET_HEAD_DIM),
                         rv.reshape(bsz, s_pad, RET_HEADS, RET_HEAD_DIM))[:, :s_len]
        ret = _head_group_norm(ret, ret_gn_gain[layer])
        ret = jax.nn.silu(rg[:, :s_len].astype(jnp.float32)) * ret
        moba = _moba_attention(mq.reshape(bsz, s_pad, MOBA_HEADS, MOBA_HEAD_DIM),
                               mk.reshape(bsz, s_pad, MOBA_HEADS, MOBA_HEAD_DIM),
                               mv.reshape(bsz, s_pad, MOBA_HEADS, MOBA_HEAD_DIM))[:, :s_len]
        moba = moba.reshape(bsz, s_len, MOBA_WIDTH)
        mixed = jnp.concatenate([ret, moba], axis=-1).astype(h.dtype) @ w_out[layer]
        h = _layer_norm(DEEPNORM_ALPHA * h + mixed, ln1_g[layer], ln1_b[layer])
        ffn = (jax.nn.silu(h @ w_gate[layer]) * (h @ w_up[layer])) @ w_down[layer]
        h = _layer_norm(DEEPNORM_ALPHA * h + ffn, ln2_g[layer], ln2_b[layer])
    return h
```

```cpp
#include <hip/hip_runtime.h>
#include <cstdio>
#include <cstdint>
namespace nv {
constexpr int B_ = 4, S_ = 8192, DM_ = 1024, T_ = B_ * S_, INW = 3584, DFF = 2816;
constexpr float ALPHA = 1.189207115002721f;
constexpr float EPS = 1e-5f;

template <int EPI>
__global__ void __launch_bounds__(256) ngemm(const float* __restrict__ A, const float* __restrict__ Bm, const float* __restrict__ B2, const float* __restrict__ R,
                                             float* __restrict__ C, int M, int N, int K, float alpha) {
    __shared__ float As[8][128];
    __shared__ float Bs[8][128];
    __shared__ float Bs2[(EPI == 2) ? 8 : 1][128];
    const int tid = threadIdx.x, tx = tid & 15, ty = tid >> 4;
    const int row0 = blockIdx.y * 128, col0 = blockIdx.x * 128;
    float acc[8][8], acc2[(EPI == 2) ? 8 : 1][8];
#pragma unroll
    for (int i = 0; i < 8; ++i)
#pragma unroll
        for (int j = 0; j < 8; ++j) { acc[i][j] = 0.f; if (EPI == 2) acc2[i][j] = 0.f; }
    const int ar = tid >> 1, ak = (tid & 1) * 4;
    const int bk = tid >> 5, bc = (tid & 31) * 4;
    for (int k0 = 0; k0 < K; k0 += 8) {
        const float4 av = *(const float4*)(A + (size_t)(row0 + ar) * K + k0 + ak);
        const float4 bv = *(const float4*)(Bm + (size_t)(k0 + bk) * N + col0 + bc);
        float4 bv2; if (EPI == 2) bv2 = *(const float4*)(B2 + (size_t)(k0 + bk) * N + col0 + bc);
        __syncthreads();
        As[ak + 0][ar] = av.x; As[ak + 1][ar] = av.y; As[ak + 2][ar] = av.z; As[ak + 3][ar] = av.w;
        *(float4*)&Bs[bk][bc] = bv;
        if (EPI == 2) *(float4*)&Bs2[bk][bc] = bv2;
        __syncthreads();
#pragma unroll
        for (int k = 0; k < 8; ++k) {
            float a[8], b[8], b2[8];
#pragma unroll
            for (int i = 0; i < 8; ++i) a[i] = As[k][ty * 8 + i];
#pragma unroll
            for (int j = 0; j < 8; ++j) { b[j] = Bs[k][tx * 8 + j]; if (EPI == 2) b2[j] = Bs2[k][tx * 8 + j]; }
#pragma unroll
            for (int i = 0; i < 8; ++i)
#pragma unroll
                for (int j = 0; j < 8; ++j) { acc[i][j] = fmaf(a[i], b[j], acc[i][j]); if (EPI == 2) acc2[i][j] = fmaf(a[i], b2[j], acc2[i][j]); }
        }
    }
#pragma unroll
    for (int i = 0; i < 8; ++i) {
        const size_t off = (size_t)(row0 + ty * 8 + i) * N + col0 + tx * 8;
#pragma unroll
        for (int j = 0; j < 8; ++j) {
            float v = acc[i][j];
            if (EPI == 1) v = fmaf(alpha, R[off + j], v);
            if (EPI == 2) { const float g = v; v = g / (1.f + __expf(-g)) * acc2[i][j]; }
            C[off + j] = v;
        }
    }
}

__global__ void nkmean(const float* __restrict__ proj, float* __restrict__ kmean) {
    const int idx = blockIdx.x * 256 + threadIdx.x;
    const int c = idx & 511, bn = idx >> 9;
    const float* p = proj + (size_t)bn * 256 * INW + 2560 + c;
    float s = 0.f;
    for (int j = 0; j < 256; ++j) s += p[(size_t)j * INW];
    kmean[idx] = s * (1.f / 256.f);
}

__global__ void __launch_bounds__(256) nret(const float* __restrict__ proj, const float* __restrict__ gain, float* __restrict__ concat) {
    __shared__ float Qs[32][129];
    __shared__ float Ks[32][129];
    __shared__ float Vs[32][128];
    __shared__ float Ss[32][33];
    const int tid = threadIdx.x;
    const int qt = blockIdx.x & 255, bh = blockIdx.x >> 8, b = bh >> 2, h = bh & 3;
    const float gamma = 1.f - exp2f(-5.f - (float)h), l2g = log2f(gamma);
    const float* base = proj + (size_t)b * S_ * INW;
    const int t0 = qt * 32;
    for (int i = tid; i < 32 * 128; i += 256) { const int r = i >> 7, d = i & 127; Qs[r][d] = base[(size_t)(t0 + r) * INW + h * 128 + d]; }
    float acc[16];
#pragma unroll
    for (int e = 0; e < 16; ++e) acc[e] = 0.f;
    const int qi = tid >> 3, sub = tid & 7;
    for (int kt = 0; kt <= qt; ++kt) {
        const int s0 = kt * 32;
        __syncthreads();
        for (int i = tid; i < 32 * 128; i += 256) { const int r = i >> 7, d = i & 127;
            Ks[r][d] = base[(size_t)(s0 + r) * INW + 512 + h * 128 + d]; Vs[r][d] = base[(size_t)(s0 + r) * INW + 1024 + h * 128 + d]; }
        __syncthreads();
#pragma unroll
        for (int jj = 0; jj < 4; ++jj) {
            const int kj = sub * 4 + jj; float s = 0.f;
            for (int d = 0; d < 128; ++d) s = fmaf(Qs[qi][d], Ks[kj][d], s);
            const int dist = (t0 + qi) - (s0 + kj);
            Ss[qi][kj] = dist >= 0 ? s * 0.08838834764831845f * exp2f((float)dist * l2g) : 0.f;
        }
        __syncthreads();
        for (int j = 0; j < 32; ++j) { const float w = Ss[qi][j];
#pragma unroll
            for (int e = 0; e < 16; ++e) acc[e] = fmaf(w, Vs[j][sub * 16 + e], acc[e]); }
    }
    float s = 0.f;
#pragma unroll
    for (int e = 0; e < 16; ++e) s += acc[e];
    s += __shfl_xor(s, 1); s += __shfl_xor(s, 2); s += __shfl_xor(s, 4);
    const float mean = s * (1.f / 128.f);
    float q = 0.f;
#pragma unroll
    for (int e = 0; e < 16; ++e) { const float d = acc[e] - mean; q += d * d; }
    q += __shfl_xor(q, 1); q += __shfl_xor(q, 2); q += __shfl_xor(q, 4);
    const float rstd = rsqrtf(q * (1.f / 128.f) + EPS);
    const size_t trow = (size_t)b * S_ + t0 + qi;
#pragma unroll
    for (int e = 0; e < 16; ++e) { const int c = h * 128 + sub * 16 + e;
        const float g = proj[trow * INW + 1536 + c];
        concat[trow * DM_ + c] = (acc[e] - mean) * rstd * gain[c] * (g / (1.f + __expf(-g))); }
}

__global__ void __launch_bounds__(256) nmoba(const float* __restrict__ proj, const float* __restrict__ kmean, float* __restrict__ concat) {
    const int j = blockIdx.x & 31, bh = blockIdx.x >> 5, b = bh >> 3, h = bh & 7;
    const int t = j * 256 + threadIdx.x;
    const float slope = exp2f(-(float)(h + 1));
    const float* base = proj + (size_t)b * S_ * INW;
    float q[64];
    { const float4* qp = (const float4*)(base + (size_t)t * INW + 2048 + h * 64);
#pragma unroll
      for (int i = 0; i < 16; ++i) { const float4 v = qp[i]; q[4 * i] = v.x * 0.125f; q[4 * i + 1] = v.y * 0.125f; q[4 * i + 2] = v.z * 0.125f; q[4 * i + 3] = v.w * 0.125f; } }
    float g0 = -INFINITY, g1 = -INFINITY, g2 = -INFINITY; int i0 = 0, i1 = 0, i2 = 0;
    for (int n = 0; n < j; ++n) {
        const float4* kp = (const float4*)(kmean + ((size_t)(b * 32 + n) * 512 + h * 64));
        float g = 0.f;
#pragma unroll
        for (int i = 0; i < 16; ++i) { const float4 v = kp[i]; g = fmaf(q[4 * i], v.x, g); g = fmaf(q[4 * i + 1], v.y, g); g = fmaf(q[4 * i + 2], v.z, g); g = fmaf(q[4 * i + 3], v.w, g); }
        if (g > g0) { g2 = g1; i2 = i1; g1 = g0; i1 = i0; g0 = g; i0 = n; }
        else if (g > g1) { g2 = g1; i2 = i1; g1 = g; i1 = n; }
        else if (g > g2) { g2 = g; i2 = n; }
    }
    const int nsel = j < 3 ? j : 3;
    float m = -INFINITY, l = 0.f, o[64];
#pragma unroll
    for (int d = 0; d < 64; ++d) o[d] = 0.f;
    for (int kb = 0; kb <= nsel; ++kb) {
        const int blk = kb == nsel ? j : (kb == 0 ? i0 : (kb == 1 ? i1 : i2));
        const int jmax = kb == nsel ? (int)threadIdx.x : 255;
        for (int jj = 0; jj <= jmax; ++jj) {
            const int tk = blk * 256 + jj;
            const float4* kp = (const float4*)(base + (size_t)tk * INW + 2560 + h * 64);
            float s = 0.f;
#pragma unroll
            for (int i = 0; i < 16; ++i) { const float4 v = kp[i]; s = fmaf(q[4 * i], v.x, s); s = fmaf(q[4 * i + 1], v.y, s); s = fmaf(q[4 * i + 2], v.z, s); s = fmaf(q[4 * i + 3], v.w, s); }
            s -= slope * (float)(t - tk);
            if (s > m) { const float f = __expf(m - s); l *= f;
#pragma unroll
                for (int d = 0; d < 64; ++d) o[d] *= f;
                m = s; }
            const float p = __expf(s - m); l += p;
            const float4* vp = (const float4*)(base + (size_t)tk * INW + 3072 + h * 64);
#pragma unroll
            for (int i = 0; i < 16; ++i) { const float4 v = vp[i]; o[4 * i] = fmaf(p, v.x, o[4 * i]); o[4 * i + 1] = fmaf(p, v.y, o[4 * i + 1]); o[4 * i + 2] = fmaf(p, v.z, o[4 * i + 2]); o[4 * i + 3] = fmaf(p, v.w, o[4 * i + 3]); }
        }
    }
    const float rl = 1.f / l;
    float4* op = (float4*)(concat + ((size_t)b * S_ + t) * DM_ + 512 + h * 64);
#pragma unroll
    for (int i = 0; i < 16; ++i) op[i] = make_float4(o[4 * i] * rl, o[4 * i + 1] * rl, o[4 * i + 2] * rl, o[4 * i + 3] * rl);
}

__global__ void __launch_bounds__(256) nln(const float* __restrict__ in, const float* __restrict__ g, const float* __restrict__ bta, float* __restrict__ out) {
    const int lane = threadIdx.x & 63, row = blockIdx.x * 4 + (threadIdx.x >> 6);
    const float4* xr = (const float4*)(in + (size_t)row * DM_) + lane;
    float4 v[4]; float s = 0.f;
#pragma unroll
    for (int k = 0; k < 4; ++k) { v[k] = xr[64 * k]; s += (v[k].x + v[k].y) + (v[k].z + v[k].w); }
#pragma unroll
    for (int o = 1; o < 64; o <<= 1) s += __shfl_xor(s, o);
    const float mean = s * (1.f / DM_); float s2 = 0.f;
#pragma unroll
    for (int k = 0; k < 4; ++k) { v[k].x -= mean; v[k].y -= mean; v[k].z -= mean; v[k].w -= mean; s2 += (v[k].x * v[k].x + v[k].y * v[k].y) + (v[k].z * v[k].z + v[k].w * v[k].w); }
#pragma unroll
    for (int o = 1; o < 64; o <<= 1) s2 += __shfl_xor(s2, o);
    const float rstd = rsqrtf(s2 * (1.f / DM_) + EPS);
    float4* orow = (float4*)(out + (size_t)row * DM_) + lane;
#pragma unroll
    for (int k = 0; k < 4; ++k) { const float4 gg = ((const float4*)g)[lane + 64 * k], bb = ((const float4*)bta)[lane + 64 * k];
        orow[64 * k] = make_float4(v[k].x * rstd * gg.x + bb.x, v[k].y * rstd * gg.y + bb.y, v[k].z * rstd * gg.z + bb.z, v[k].w * rstd * gg.w + bb.w); }
}

static void forward(void* const* d_in, void* d_out, void* d_ws, hipStream_t stream) {
    const float* x = (const float*)d_in[0]; const float* w_in = (const float*)d_in[1]; const float* gn = (const float*)d_in[2]; const float* w_out = (const float*)d_in[3];
    const float* ln1g = (const float*)d_in[4]; const float* ln1b = (const float*)d_in[5]; const float* wg = (const float*)d_in[6]; const float* wu = (const float*)d_in[7];
    const float* wd = (const float*)d_in[8]; const float* ln2g = (const float*)d_in[9]; const float* ln2b = (const float*)d_in[10];
    float* out = (float*)d_out; char* ws = (char*)d_ws; const size_t Mi = 1u << 20;
    float* proj = (float*)ws;
    float* kmean = (float*)(ws + 448 * Mi);
    float* concat = out;
    ngemm<0><<<dim3(INW / 128, T_ / 128), 256, 0, stream>>>(x, w_in, nullptr, nullptr, proj, T_, INW, DM_, 0.f);
    nkmean<<<(B_ * 32 * 512) / 256, 256, 0, stream>>>(proj, kmean);
    nret<<<16 * 256, 256, 0, stream>>>(proj, gn, concat);
    nmoba<<<32 * 32, 256, 0, stream>>>(proj, kmean, concat);
    float* y1 = (float*)ws;
    ngemm<1><<<dim3(DM_ / 128, T_ / 128), 256, 0, stream>>>(concat, w_out, nullptr, x, y1, T_, DM_, DM_, ALPHA);
    float* h1 = out;
    nln<<<T_ / 4, 256, 0, stream>>>(y1, ln1g, ln1b, h1);
    float* act = (float*)ws;
    ngemm<2><<<dim3(DFF / 128, T_ / 128), 256, 0, stream>>>(h1, wg, wu, nullptr, act, T_, DFF, DM_, 0.f);
    float* y2 = (float*)(ws + 352 * Mi);
    ngemm<1><<<dim3(DM_ / 128, T_ / 128), 256, 0, stream>>>(act, wd, nullptr, h1, y2, T_, DM_, DFF, ALPHA);
    nln<<<T_ / 4, 256, 0, stream>>>(y2, ln2g, ln2b, out);
}
}

extern "C" void kernel_launch(void* const* d_in, const int* in_sizes, int n_in, void* d_out, int out_size, void* d_ws, size_t ws_size, hipStream_t stream) {
    (void)in_sizes; (void)n_in; (void)out_size; (void)ws_size;
    nv::forward(d_in, d_out, d_ws, stream);
}
```
